# Optimizing an MI355X kernel written in HIP

```python
import jax, jax.numpy as jnp
from jax import lax
import numpy as np

D_MODEL = 1024
BATCH = 2
SEQ = 8192
DEPTH = 1

D_MIX = 2 * D_MODEL
D_POOL = D_MIX // 2
D_SGU = D_MIX - D_POOL
POOL_WINDOWS = (2, 4, 8, 16)
N_POOL_GROUPS = len(POOL_WINDOWS)
POOL_GROUP = D_POOL // N_POOL_GROUPS
N_SGU_HEADS = 4
SGU_HEAD = D_SGU // N_SGU_HEADS
CHUNK = 128
D_PLE = 256
D_IN = D_POOL + 2 * D_SGU + D_MIX
DEEPNORM_ALPHA = (2 * DEPTH) ** 0.25
DEEPNORM_BETA = (8 * DEPTH) ** -0.25
LN_EPS = 1e-5

kernel_name = "hybrid_pool_sgu_deepnorm_block"


def layer_norm(x, g, b):
    xf = x.astype(jnp.float32)
    mu = jnp.mean(xf, axis=-1, keepdims=True)
    var = jnp.mean(jnp.square(xf - mu), axis=-1, keepdims=True)
    return ((xf - mu) * lax.rsqrt(var + LN_EPS)).astype(x.dtype) * g + b


def pool_mixer(a, pool_w, pool_scale):
    bsz, s, _ = a.shape
    a4 = a.reshape(bsz, s, N_POOL_GROUPS, POOL_GROUP)
    cs = jnp.cumsum(a4.astype(jnp.float32), axis=1)
    t = jnp.arange(s)
    outs = []
    for g, w in enumerate(POOL_WINDOWS):
        c = cs[:, :, g]
        lower = jnp.pad(c, ((0, 0), (w, 0), (0, 0)))[:, :s]
        cnt = jnp.minimum(t + 1, w).astype(jnp.float32)[None, :, None]
        outs.append((c - lower) / cnt)
    pooled = jnp.stack(outs, axis=2).astype(a.dtype) - a4
    mixed = jnp.einsum('bsgc,gcd->bsgd', pooled, pool_w)
    return mixed.reshape(bsz, s, D_POOL) * pool_scale


def spatial_gating(u, v, ln_g, ln_b, w_s, b_s):
    bsz, s, _ = u.shape
    u = jax.nn.gelu(u)
    v = jax.nn.gelu(v)
    vh = v.reshape(bsz, s, N_SGU_HEADS, SGU_HEAD)
    vh = layer_norm(vh, ln_g.reshape(N_SGU_HEADS, SGU_HEAD), ln_b.reshape(N_SGU_HEADS, SGU_HEAD))
    vc = vh.reshape(bsz, s // CHUNK, CHUNK, N_SGU_HEADS, SGU_HEAD)
    mask = jnp.tril(jnp.ones((CHUNK, CHUNK), dtype=bool))
    w = jnp.where(mask[None], w_s, jnp.zeros_like(w_s))
    sv = jnp.einsum('hij,bnjhc->bnihc', w, vc) + b_s.T[None, None, :, :, None]
    return u * sv.reshape(bsz, s, D_SGU)


def setup_inputs(seed: int = 0) -> dict:
    key = jax.random.key(seed)
    ks = jax.random.split(key, 16)
    nrm = jax.random.normal
    f32 = jnp.float32
    x = nrm(ks[0], (BATCH, SEQ, D_MODEL), f32)
    p = nrm(ks[1], (DEPTH, BATCH, SEQ, D_PLE), f32)
    w_in = nrm(ks[2], (DEPTH, D_MODEL, D_IN), f32) * D_MODEL ** -0.5
    pool_w = nrm(ks[3], (DEPTH, N_POOL_GROUPS, POOL_GROUP, POOL_GROUP), f32) * POOL_GROUP ** -0.5
    pool_scale = 1.0 + 0.1 * nrm(ks[4], (DEPTH, D_POOL), f32)
    sgu_ln_g = 1.0 + 0.02 * nrm(ks[5], (DEPTH, D_SGU), f32)
    sgu_ln_b = 0.02 * nrm(ks[6], (DEPTH, D_SGU), f32)
    sgu_w = nrm(ks[7], (DEPTH, N_SGU_HEADS, CHUNK, CHUNK), f32) * (0.5 * CHUNK ** -0.5)
    sgu_b = 1.0 + 0.01 * nrm(ks[8], (DEPTH, N_SGU_HEADS, CHUNK), f32)
    w_out = nrm(ks[9], (DEPTH, D_MIX, D_MODEL), f32) * (D_MIX ** -0.5 * DEEPNORM_BETA)
    ln_g = 1.0 + 0.02 * nrm(ks[10], (DEPTH, D_MODEL), f32)
    ln_b = 0.02 * nrm(ks[11], (DEPTH, D_MODEL), f32)
    ple_w = nrm(ks[12], (DEPTH, D_PLE, D_MODEL), f32) * D_PLE ** -0.5
    ple_gate_w = nrm(ks[13], (DEPTH, D_MODEL, D_MODEL), f32) * D_MODEL ** -0.5
    ple_gate_b = 0.02 * nrm(ks[14], (DEPTH, D_MODEL), f32)
    return {"x": x, "p": p, "w_in": w_in, "pool_w": pool_w, "pool_scale": pool_scale,
            "sgu_ln_g": sgu_ln_g, "sgu_ln_b": sgu_ln_b, "sgu_w": sgu_w, "sgu_b": sgu_b,
            "w_out": w_out, "ln_g": ln_g, "ln_b": ln_b, "ple_w": ple_w,
            "ple_gate_w": ple_gate_w, "ple_gate_b": ple_gate_b}


def reference(x, p, w_in, pool_w, pool_scale, sgu_ln_g, sgu_ln_b, sgu_w, sgu_b,
              w_out, ln_g, ln_b, ple_w, ple_gate_w, ple_gate_b):
    for i in range(DEPTH):
        h = jnp.einsum('bsd,de->bse', x, w_in[i])
        a, u, v, z = jnp.split(h, [D_POOL, D_POOL + D_SGU, D_POOL + 2 * D_SGU], axis=-1)
        y_pool = pool_mixer(a, pool_w[i], pool_scale[i])
        y_sgu = spatial_gating(u, v, sgu_ln_g[i], sgu_ln_b[i], sgu_w[i], sgu_b[i])
        y = jnp.concatenate([y_pool, y_sgu], axis=-1) * jax.nn.silu(z)
        mix = jnp.einsum('bse,ed->bsd', y, w_out[i])
        x = layer_norm(DEEPNORM_ALPHA * x + mix, ln_g[i], ln_b[i])
        gate = jax.nn.sigmoid(jnp.einsum('bsd,de->bse', x, ple_gate_w[i]) + ple_gate_b[i])
        x = x + gate * jnp.einsum('bsk,kd->bsd', p[i], ple_w[i])
    return x
```

```cpp
#include <hip/hip_runtime.h>
#include <cstdio>
#include <cstdint>

constexpr int M = 16384, SEQ = 8192, DM = 1024, DIN = 5120, DMIX = 2048, DPLE = 256;
constexpr float LN_EPS = 1e-5f;
constexpr float ALPHA = 1.18920711500272f;

__global__ void __launch_bounds__(256) gemm_f32(const float* __restrict__ A, int lda, const float* __restrict__ B, int ldb, float* C, int ldc, int K, int beta) {
    __shared__ float As[16][68];
    __shared__ float Bs[16][68];
    const int tid = threadIdx.x, tx = tid & 15, ty = tid >> 4;
    const int m0 = blockIdx.y * 64, n0 = blockIdx.x * 64;
    float acc[4][4] = {};
    for (int k0 = 0; k0 < K; k0 += 16) {
        {
            const int r = tid >> 2, c4 = (tid & 3) * 4;
            const float4 v = *(const float4*)(A + (size_t)(m0 + r) * lda + k0 + c4);
            As[c4 + 0][r] = v.x; As[c4 + 1][r] = v.y; As[c4 + 2][r] = v.z; As[c4 + 3][r] = v.w;
        }
        {
            const int r = tid >> 4, c4 = (tid & 15) * 4;
            const float4 v = *(const float4*)(B + (size_t)(k0 + r) * ldb + n0 + c4);
            Bs[r][c4 + 0] = v.x; Bs[r][c4 + 1] = v.y; Bs[r][c4 + 2] = v.z; Bs[r][c4 + 3] = v.w;
        }
        __syncthreads();
#pragma unroll
        for (int k = 0; k < 16; ++k) {
            float a[4], b[4];
#pragma unroll
            for (int i = 0; i < 4; ++i) { a[i] = As[k][ty * 4 + i]; b[i] = Bs[k][tx * 4 + i]; }
#pragma unroll
            for (int i = 0; i < 4; ++i)
#pragma unroll
                for (int j = 0; j < 4; ++j) acc[i][j] += a[i] * b[j];
        }
        __syncthreads();
    }
#pragma unroll
    for (int i = 0; i < 4; ++i)
#pragma unroll
        for (int j = 0; j < 4; ++j) {
            float* c = C + (size_t)(m0 + ty * 4 + i) * ldc + n0 + tx * 4 + j;
            *c = (beta ? *c : 0.f) + acc[i][j];
        }
}

__device__ __forceinline__ float gelu_tanh(float x) { const float y = 0.7978845608028654f * (x + 0.044715f * x * x * x); return 0.5f * x * (1.f + tanhf(y)); }
__device__ __forceinline__ float silu(float x) { return x / (1.f + expf(-x)); }

__global__ void pool_kernel(const float* __restrict__ a, float* __restrict__ pooled) {
    const size_t idx = (size_t)blockIdx.x * blockDim.x + threadIdx.x;
    const int c = (int)(idx % 1024); const int m = (int)(idx / 1024);
    const int t = m % SEQ; const int g = c / 256; const int w = 2 << g;
    const int n = (t + 1 < w) ? (t + 1) : w;
    float s = 0.f;
    for (int d = 0; d < n; ++d) s += a[(size_t)(m - d) * 1024 + c];
    pooled[idx] = s / (float)n - a[idx];
}
__global__ void pool_combine(float* __restrict__ y, const float* __restrict__ z, const float* __restrict__ scale) {
    const size_t idx = (size_t)blockIdx.x * blockDim.x + threadIdx.x;
    const int c = (int)(idx % 1024);
    y[idx] = y[idx] * scale[c] * silu(z[idx]);
}
__global__ void sgu_ln(const float* __restrict__ v, float* __restrict__ vln, const float* __restrict__ g, const float* __restrict__ b) {
    const int wave = (blockIdx.x * blockDim.x + threadIdx.x) >> 6, lane = threadIdx.x & 63;
    const int m = wave >> 2, h = wave & 3;
    const float* src = v + (size_t)m * 1024 + h * 256;
    float x[4]; float s = 0.f;
#pragma unroll
    for (int i = 0; i < 4; ++i) { x[i] = gelu_tanh(src[lane + 64 * i]); s += x[i]; }
#pragma unroll
    for (int o = 1; o < 64; o <<= 1) s += __shfl_xor(s, o);
    const float mu = s * (1.f / 256.f); float q = 0.f;
#pragma unroll
    for (int i = 0; i < 4; ++i) { x[i] -= mu; q += x[i] * x[i]; }
#pragma unroll
    for (int o = 1; o < 64; o <<= 1) q += __shfl_xor(q, o);
    const float rstd = rsqrtf(q * (1.f / 256.f) + LN_EPS);
#pragma unroll
    for (int i = 0; i < 4; ++i) { const int c = h * 256 + lane + 64 * i; vln[(size_t)m * 1024 + c] = x[i] * rstd * g[c] + b[c]; }
}
__global__ void sgu_mix(const float* __restrict__ vln, float* __restrict__ t, const float* __restrict__ w, const float* __restrict__ bs) {
    const size_t idx = (size_t)blockIdx.x * blockDim.x + threadIdx.x;
    const int col = (int)(idx % 1024); const int m = (int)(idx / 1024);
    const int h = col / 256; const int i = m % 128; const int m0 = m - i;
    const float* wr = w + ((size_t)h * 128 + i) * 128;
    float s = 0.f;
    for (int j = 0; j <= i; ++j) s += wr[j] * vln[(size_t)(m0 + j) * 1024 + col];
    t[idx] = s + bs[h * 128 + i];
}
__global__ void sgu_mul_u(float* __restrict__ t, const float* __restrict__ u) {
    const size_t idx = (size_t)blockIdx.x * blockDim.x + threadIdx.x;
    t[idx] = gelu_tanh(u[idx]) * t[idx];
}
__global__ void mul_silu(float* __restrict__ t, const float* __restrict__ z) {
    const size_t idx = (size_t)blockIdx.x * blockDim.x + threadIdx.x;
    t[idx] = t[idx] * silu(z[idx]);
}
__global__ void deepnorm_ln(const float* __restrict__ x, const float* __restrict__ mix, float* __restrict__ out, const float* __restrict__ g, const float* __restrict__ b) {
    const int wave = (blockIdx.x * blockDim.x + threadIdx.x) >> 6, lane = threadIdx.x & 63;
    const size_t base = (size_t)wave * 1024;
    float v[16]; float s = 0.f;
#pragma unroll
    for (int i = 0; i < 16; ++i) { v[i] = ALPHA * x[base + lane + 64 * i] + mix[base + lane + 64 * i]; s += v[i]; }
#pragma unroll
    for (int o = 1; o < 64; o <<= 1) s += __shfl_xor(s, o);
    const float mu = s * (1.f / 1024.f); float q = 0.f;
#pragma unroll
    for (int i = 0; i < 16; ++i) { v[i] -= mu; q += v[i] * v[i]; }
#pragma unroll
    for (int o = 1; o < 64; o <<= 1) q += __shfl_xor(q, o);
    const float rstd = rsqrtf(q * (1.f / 1024.f) + LN_EPS);
#pragma unroll
    for (int i = 0; i < 16; ++i) { const int c = lane + 64 * i; out[base + c] = v[i] * rstd * g[c] + b[c]; }
}
__global__ void final_combine(float* __restrict__ out, const float* __restrict__ gate, const float* __restrict__ pe, const float* __restrict__ bg) {
    const size_t idx = (size_t)blockIdx.x * blockDim.x + threadIdx.x;
    const int c = (int)(idx % 1024);
    const float gt = 1.f / (1.f + expf(-(gate[idx] + bg[c])));
    out[idx] = out[idx] + gt * pe[idx];
}

static void gemm(const float* A, int lda, const float* B, int ldb, float* C, int ldc, int m, int n, int k, int beta, hipStream_t s) {
    hipLaunchKernelGGL(gemm_f32, dim3(n / 64, m / 64), dim3(256), 0, s, A, lda, B, ldb, C, ldc, k, beta);
}

extern "C" void kernel_launch(void* const* d_in, const int* in_sizes, int n_in, void* d_out, int out_size, void* d_ws, size_t ws_size, hipStream_t stream) {
    const float* x = (const float*)d_in[0];       const float* p = (const float*)d_in[1];
    const float* w_in = (const float*)d_in[2];    const float* pool_w = (const float*)d_in[3];
    const float* pool_scale = (const float*)d_in[4]; const float* sgu_ln_g = (const float*)d_in[5];
    const float* sgu_ln_b = (const float*)d_in[6];   const float* sgu_w = (const float*)d_in[7];
    const float* sgu_b = (const float*)d_in[8];      const float* w_out = (const float*)d_in[9];
    const float* ln_g = (const float*)d_in[10];      const float* ln_b = (const float*)d_in[11];
    const float* ple_w = (const float*)d_in[12];     const float* ple_gate_w = (const float*)d_in[13];
    const float* ple_gate_b = (const float*)d_in[14];
    float* out = (float*)d_out;
    const size_t BUF = (size_t)M * 1024;
    float* B0 = (float*)d_ws; float* B1 = B0 + BUF; float* B2 = B1 + BUF;
    const int EW = (int)(BUF / 256);
    gemm(x, DM, w_in + 0, DIN, B0, 1024, M, 1024, DM, 0, stream);
    hipLaunchKernelGGL(pool_kernel, dim3(EW), dim3(256), 0, stream, B0, B1);
    for (int g = 0; g < 4; ++g) gemm(B1 + g * 256, 1024, pool_w + (size_t)g * 65536, 256, B0 + g * 256, 1024, M, 256, 256, 0, stream);
    gemm(x, DM, w_in + 3072, DIN, B1, 1024, M, 1024, DM, 0, stream);
    hipLaunchKernelGGL(pool_combine, dim3(EW), dim3(256), 0, stream, B0, B1, pool_scale);
    gemm(x, DM, w_in + 2048, DIN, B1, 1024, M, 1024, DM, 0, stream);
    hipLaunchKernelGGL(sgu_ln, dim3(M * 4 / 4), dim3(256), 0, stream, B1, B2, sgu_ln_g, sgu_ln_b);
    hipLaunchKernelGGL(sgu_mix, dim3(EW), dim3(256), 0, stream, B2, B1, sgu_w, sgu_b);
    gemm(x, DM, w_in + 1024, DIN, B2, 1024, M, 1024, DM, 0, stream);
    hipLaunchKernelGGL(sgu_mul_u, dim3(EW), dim3(256), 0, stream, B1, B2);
    gemm(x, DM, w_in + 4096, DIN, B2, 1024, M, 1024, DM, 0, stream);
    hipLaunchKernelGGL(mul_silu, dim3(EW), dim3(256), 0, stream, B1, B2);
    gemm(B0, 1024, w_out, 1024, B2, 1024, M, 1024, 1024, 0, stream);
    gemm(B1, 1024, w_out + (size_t)1024 * 1024, 1024, B2, 1024, M, 1024, 1024, 1, stream);
    hipLaunchKernelGGL(deepnorm_ln, dim3(M / 4), dim3(256), 0, stream, x, B2, out, ln_g, ln_b);
    gemm(out, 1024, ple_gate_w, 1024, B0, 1024, M, 1024, 1024, 0, stream);
    gemm(p, DPLE, ple_w, 1024, B1, 1024, M, 1024, DPLE, 0, stream);
    hipLaunchKernelGGL(final_combine, dim3(EW), dim3(256), 0, stream, out, B0, B1, ple_gate_b);
}
```
